# Optimizing an MI355X kernel written in HIP

```python
import jax, jax.numpy as jnp
from jax import lax
import numpy as np

D_MODEL = 1024
BATCH = 8
SEQ = 2048
DEPTH = 1
DEC_BATCH = 128
DEC_SEQ = 4
PAST_LEN = 16384
PAGE_SIZE = 128

MIX_W = D_MODEL
MLSTM_W = MIX_W // 2
NH_M = 4
DV = MLSTM_W // NH_M
DK = DV // 2
CONV_CH = MIX_W - MLSTM_W
CONV_W = 3
D_FF = ((8 * D_MODEL + 3 * 256 - 1) // (3 * 256)) * 256
PLE_DIM = 256
CHUNK = 64
GATE_CAP = 15.0
EPS = 1e-6
PROJ_W = 2 * NH_M * DK + MLSTM_W + 2 * NH_M + MLSTM_W + 3 * CONV_CH

kernel_name = "hymba_mlstm_shortconv_decode_step"


def rmsnorm(x, g):
    xf = x.astype(jnp.float32)
    y = xf * lax.rsqrt(jnp.mean(xf * xf, axis=-1, keepdims=True) + EPS)
    return (y * g.astype(jnp.float32)).astype(x.dtype)


def mlstm_chunkwise(q, k, v, ig, lf, C0, n0, m0, chunk):
    Bn, H, S, _ = q.shape
    nc = S // chunk

    def to_chunks(a):
        a = a.reshape(a.shape[:2] + (nc, chunk) + a.shape[3:])
        return jnp.moveaxis(a, 2, 0)

    xs = tuple(to_chunks(a) for a in (q, k, v, ig, lf))
    causal = jnp.tril(jnp.ones((chunk, chunk), dtype=bool))

    def step(carry, inp):
        C, n, m = carry
        qc, kc, vc, ic, fc = inp
        b = jnp.cumsum(fc, axis=-1)
        g = b + m[..., None]
        Dm = b[..., :, None] - b[..., None, :] + ic[..., None, :]
        Dm = jnp.where(causal, Dm, -jnp.inf)
        mt = jnp.maximum(g, jnp.max(Dm, axis=-1))
        w_inter = jnp.exp(g - mt)
        s = jnp.einsum('bhtd,bhsd->bhts', qc, kc) * jnp.exp(Dm - mt[..., None])
        num = (w_inter[..., None] * jnp.einsum('bhtd,bhde->bhte', qc, C)
               + jnp.einsum('bhts,bhse->bhte', s, vc))
        den = w_inter * jnp.einsum('bhtd,bhd->bht', qc, n) + jnp.sum(s, axis=-1)
        h = num / jnp.maximum(jnp.abs(den), jnp.exp(-mt))[..., None]
        bL = b[..., -1]
        dL = bL[..., None] - b + ic
        m_new = jnp.maximum(bL + m, jnp.max(dL, axis=-1))
        a_st = jnp.exp(bL + m - m_new)
        wk = jnp.exp(dL - m_new[..., None])
        C_new = a_st[..., None, None] * C + jnp.einsum('bhs,bhsd,bhse->bhde', wk, kc, vc)
        n_new = a_st[..., None] * n + jnp.einsum('bhs,bhsd->bhd', wk, kc)
        return (C_new, n_new, m_new), h

    carry0 = (C0.astype(jnp.float32), n0.astype(jnp.float32), m0.astype(jnp.float32))
    (C, n, m), hs = lax.scan(step, carry0, xs)
    h = jnp.moveaxis(hs, 0, 2).reshape(Bn, H, S, v.shape[-1])
    return h, C, n, m


def hybrid_layer(x, pe, C0, n0, m0, conv0, chunk, g_mix, w_in, b_ig, b_fg, g_mh, conv_w, w_out,
                 g_ffn, w_gate, w_up, w_down, w_ple, g_ple, w_pg):
    Bn, S, _ = x.shape
    a = rmsnorm(x, g_mix)
    u = a @ w_in
    sizes = [NH_M * DK, NH_M * DK, MLSTM_W, NH_M, NH_M, MLSTM_W, CONV_CH, CONV_CH, CONV_CH]
    idx = [int(c) for c in np.cumsum(sizes)[:-1]]
    q, k, v, ig, fg, og, bg, cg, hc = jnp.split(u, idx, axis=-1)

    def heads(t, d):
        return t.reshape(Bn, S, NH_M, d).transpose(0, 2, 1, 3).astype(jnp.float32)

    qh = heads(q, DK) * (DK ** -0.5)
    kh = heads(k, DK)
    vh = heads(v, DV)
    igh = (GATE_CAP * jnp.tanh((ig + b_ig).astype(jnp.float32) / GATE_CAP)).transpose(0, 2, 1)
    lfh = jax.nn.log_sigmoid((fg + b_fg).astype(jnp.float32)).transpose(0, 2, 1)
    h, C, n, m = mlstm_chunkwise(qh, kh, vh, igh, lfh, C0, n0, m0, chunk)
    h = h.transpose(0, 2, 1, 3)
    h = h * lax.rsqrt(jnp.mean(h * h, axis=-1, keepdims=True) + EPS)
    h = h.reshape(Bn, S, MLSTM_W) * g_mh.astype(jnp.float32)
    h_m = (jax.nn.sigmoid(og.astype(jnp.float32)) * h).astype(x.dtype)

    z = cg * hc
    zp = jnp.concatenate([conv0.astype(z.dtype), z], axis=1)
    yconv = conv_w[0] * zp[:, 0:S]
    for j in range(1, CONV_W):
        yconv = yconv + conv_w[j] * zp[:, j:j + S]
    y_c = (bg * yconv).astype(x.dtype)
    new_conv = zp[:, S:]

    x = x + jnp.concatenate([h_m, y_c], axis=-1) @ w_out
    f = rmsnorm(x, g_ffn)
    x = x + (jax.nn.silu(f @ w_gate) * (f @ w_up)) @ w_down
    e = rmsnorm(pe @ w_ple, g_ple)
    x = x + jax.nn.sigmoid(x @ w_pg) * e
    return x, C, n, m, new_conv


def setup_inputs(seed: int = 0) -> dict:
    key = jax.random.key(seed)
    ks = jax.random.split(key, 24)
    nrm = jax.random.normal
    f32 = jnp.float32
    d = {}
    d["x_prompt"] = nrm(ks[0], (BATCH, SEQ, D_MODEL), f32)
    d["x_sample"] = nrm(ks[1], (DEC_BATCH, DEC_SEQ, D_MODEL), f32)
    d["p_prompt"] = nrm(ks[2], (DEPTH, BATCH, SEQ, PLE_DIM), f32)
    d["p_sample"] = nrm(ks[3], (DEPTH, DEC_BATCH, DEC_SEQ, PLE_DIM), f32)
    d["state_C"] = 0.5 * nrm(ks[4], (DEPTH, DEC_BATCH, NH_M, DK, DV), f32)
    d["state_n"] = 0.5 * nrm(ks[5], (DEPTH, DEC_BATCH, NH_M, DK), f32)
    d["state_m"] = 1.0 + 0.5 * nrm(ks[6], (DEPTH, DEC_BATCH, NH_M), f32)
    d["state_conv"] = nrm(ks[7], (DEPTH, DEC_BATCH, CONV_W - 1, CONV_CH), f32)
    d["g_mix"] = 1.0 + 0.02 * nrm(ks[8], (DEPTH, D_MODEL), f32)
    d["w_in"] = nrm(ks[9], (DEPTH, D_MODEL, PROJ_W), f32) * D_MODEL ** -0.5
    d["b_ig"] = 0.1 * nrm(ks[10], (DEPTH, NH_M), f32)
    d["b_fg"] = 3.0 + 0.1 * nrm(ks[11], (DEPTH, NH_M), f32)
    d["g_mh"] = 1.0 + 0.02 * nrm(ks[12], (DEPTH, MLSTM_W), f32)
    d["conv_w"] = nrm(ks[13], (DEPTH, CONV_W, CONV_CH), f32) * CONV_W ** -0.5
    d["w_out"] = nrm(ks[14], (DEPTH, MIX_W, D_MODEL), f32) * MIX_W ** -0.5
    d["g_ffn"] = 1.0 + 0.02 * nrm(ks[15], (DEPTH, D_MODEL), f32)
    d["w_gate"] = nrm(ks[16], (DEPTH, D_MODEL, D_FF), f32) * D_MODEL ** -0.5
    d["w_up"] = nrm(ks[17], (DEPTH, D_MODEL, D_FF), f32) * D_MODEL ** -0.5
    d["w_down"] = nrm(ks[18], (DEPTH, D_FF, D_MODEL), f32) * D_FF ** -0.5
    d["w_ple"] = nrm(ks[19], (DEPTH, PLE_DIM, D_MODEL), f32) * PLE_DIM ** -0.5
    d["g_ple"] = 1.0 + 0.02 * nrm(ks[20], (DEPTH, D_MODEL), f32)
    d["w_pg"] = nrm(ks[21], (DEPTH, D_MODEL, D_MODEL), f32) * D_MODEL ** -0.5
    d["g_final"] = 1.0 + 0.02 * nrm(ks[22], (D_MODEL,), f32)
    return d


def reference(x_prompt, x_sample, p_prompt, p_sample, state_C, state_n, state_m, state_conv,
              g_mix, w_in, b_ig, b_fg, g_mh, conv_w, w_out, g_ffn, w_gate, w_up, w_down,
              w_ple, g_ple, w_pg, g_final):
    xp, xs = x_prompt, x_sample
    Bp = xp.shape[0]
    Sp = xp.shape[1]
    chunk_p = min(CHUNK, Sp)
    chunk_s = xs.shape[1]
    Cp_l, np_l, mp_l, cvp_l = [], [], [], []
    Cs_l, ns_l, ms_l, cvs_l = [], [], [], []
    for i in range(DEPTH):
        w = (g_mix[i], w_in[i], b_ig[i], b_fg[i], g_mh[i], conv_w[i], w_out[i], g_ffn[i],
             w_gate[i], w_up[i], w_down[i], w_ple[i], g_ple[i], w_pg[i])
        C0 = jnp.zeros((Bp, NH_M, DK, DV), jnp.float32)
        n0 = jnp.zeros((Bp, NH_M, DK), jnp.float32)
        m0 = jnp.zeros((Bp, NH_M), jnp.float32)
        cv0 = jnp.zeros((Bp, CONV_W - 1, CONV_CH), xp.dtype)
        xp, Cp, n_p, mp, cvp = hybrid_layer(xp, p_prompt[i], C0, n0, m0, cv0, chunk_p, *w)
        xs, Cs, n_s, ms, cvs = hybrid_layer(xs, p_sample[i], state_C[i], state_n[i], state_m[i],
                                            state_conv[i], chunk_s, *w)
        Cp_l.append(Cp); np_l.append(n_p); mp_l.append(mp); cvp_l.append(cvp)
        Cs_l.append(Cs); ns_l.append(n_s); ms_l.append(ms); cvs_l.append(cvs)
    y_prompt = rmsnorm(xp, g_final)
    y_sample = rmsnorm(xs, g_final)
    C_prompt = jnp.stack(Cp_l); n_prompt = jnp.stack(np_l); m_prompt = jnp.stack(mp_l); conv_prompt = jnp.stack(cvp_l)
    C_sample = jnp.stack(Cs_l); n_sample = jnp.stack(ns_l); m_sample = jnp.stack(ms_l); conv_sample = jnp.stack(cvs_l)
    return (y_prompt, y_sample, C_prompt, n_prompt, m_prompt, conv_prompt, C_sample, n_sample, m_sample, conv_sample)
```

```cpp
#include <hip/hip_runtime.h>
#include <cstdio>
#include <cstdint>

#define LAS __attribute__((address_space(3)))
#define GAS __attribute__((address_space(1)))
typedef unsigned short bf16_t;
typedef short bf16x8 __attribute__((ext_vector_type(8)));
typedef short s16x4 __attribute__((ext_vector_type(4)));
typedef float f32x4 __attribute__((ext_vector_type(4)));
typedef float f32x2 __attribute__((ext_vector_type(2)));
typedef unsigned u32x4 __attribute__((ext_vector_type(4)));
typedef unsigned u32x2 __attribute__((ext_vector_type(2)));
typedef GAS unsigned gu32;

#ifndef MK_N_LAUNCHES
#define MK_N_LAUNCHES 10
#endif

constexpr int TP = 16384, TS = 512, TT = TP + TS;
constexpr int DM = 1024, PROJ = 3080, NU = 3072, DFF = 2816, NGU = 2 * DFF, PLE = 256;
constexpr int NH = 4, DK = 64, DV = 128, NCH = 32;
constexpr float EPS = 1e-6f, GATE_CAP = 15.0f;
constexpr int NPAN = TT / 256;

constexpr size_t KiB = 1024, MiB = 1u << 20;
constexpr size_t WS_CTL = 0, CTL_ZERO_BYTES = 1 * MiB;
constexpr size_t WS_WIN = 1 * MiB;
constexpr size_t WS_WOUT = 7 * MiB;
constexpr size_t WS_WGU = 9 * MiB;
constexpr size_t WS_WDOWN = 20 * MiB;
constexpr size_t WS_WPLE = 20 * MiB + 5632 * KiB;
constexpr size_t WS_WPG = 26 * MiB;
constexpr size_t WS_R1 = 28 * MiB;
constexpr size_t WS_PB = 61 * MiB;
constexpr size_t WS_GATES = 69 * MiB + 512 * KiB;
constexpr size_t WS_SSQ1 = 70 * MiB + 256 * KiB;
constexpr size_t WS_SSQE = WS_SSQ1 + (size_t)TT * 64;
constexpr size_t WS_SSQ3 = WS_SSQE + (size_t)TT * 64;
constexpr size_t WS_UN = 73 * MiB + 512 * KiB;
constexpr size_t WS_NS = WS_UN + 256 * KiB;
constexpr size_t WS_BL = WS_NS + 256 * KiB;
constexpr size_t WS_MLOC = WS_BL + 4 * KiB;
constexpr size_t WS_CST = 74 * MiB + 512 * KiB;
constexpr size_t WS_U = 90 * MiB + 512 * KiB;
constexpr size_t WS_R2 = 189 * MiB + 512 * KiB;
constexpr size_t WS_E = 222 * MiB + 512 * KiB;
constexpr size_t WS_END = 255 * MiB + 512 * KiB;
static_assert(WS_WPLE + 512 * KiB <= WS_WPG && WS_SSQ3 + (size_t)TT * 64 <= WS_UN && WS_MLOC + 4 * KiB <= WS_CST && WS_END <= 256 * MiB, "ws map");

constexpr size_t OUT_Y = 0;
constexpr size_t OUT_CP = (size_t)TT * DM;
constexpr size_t OUT_NP = OUT_CP + 8 * 4 * 64 * 128;
constexpr size_t OUT_MP = OUT_NP + 8 * 4 * 64;
constexpr size_t OUT_CVP = OUT_MP + 32;
constexpr size_t OUT_CS = OUT_CVP + 8 * 2 * 512;
constexpr size_t OUT_NS = OUT_CS + (size_t)128 * 4 * 64 * 128;
constexpr size_t OUT_MS = OUT_NS + 128 * 4 * 64;
constexpr size_t OUT_CVS = OUT_MS + 512;
constexpr size_t OUT_END = OUT_CVS + 128 * 2 * 512;

constexpr int CW_BAR = 4096;

constexpr int RING_BYTES = 131072;
constexpr int LDS_BYTES = 147456;
constexpr int MISC_OFF = LDS_BYTES - 256;

#define LDS_WAIT() asm volatile("s_waitcnt lgkmcnt(0)" ::: "memory")
#define VM_WAIT() asm volatile("s_waitcnt vmcnt(0)" ::: "memory")

__device__ __forceinline__ unsigned f2bf(float f) { unsigned u = __builtin_bit_cast(unsigned, f); return (u + 0x7fffu + ((u >> 16) & 1u)) >> 16; }
__device__ __forceinline__ unsigned pk2(float lo, float hi) { return f2bf(lo) | (f2bf(hi) << 16); }
__device__ __forceinline__ unsigned cvt_pk_bf16(float lo, float hi) { unsigned r; asm volatile("v_cvt_pk_bf16_f32 %0, %1, %2" : "=v"(r) : "v"(lo), "v"(hi)); return r; }
__device__ __forceinline__ float bf_lo(unsigned w) { return __builtin_bit_cast(float, w << 16); }
__device__ __forceinline__ float bf_hi(unsigned w) { return __builtin_bit_cast(float, w & 0xffff0000u); }
__device__ __forceinline__ float bf1(bf16_t h) { return __builtin_bit_cast(float, (unsigned)h << 16); }
__device__ __forceinline__ float sigmoidf_(float x) { return 1.0f / (1.0f + __expf(-x)); }
__device__ __forceinline__ float wave_sum(float v) {
#pragma unroll
    for (int o = 1; o < 64; o <<= 1) v += __shfl_xor(v, o);
    return v;
}
__device__ __forceinline__ float wave_max(float v) {
#pragma unroll
    for (int o = 1; o < 64; o <<= 1) v = fmaxf(v, __shfl_xor(v, o));
    return v;
}
__device__ __forceinline__ float wave_incl_scan(float v, int lane) {
#pragma unroll
    for (int o = 1; o < 64; o <<= 1) { const float t = __shfl_up(v, o); if (lane >= o) v += t; }
    return v;
}

namespace pg8 {
constexpr int BM = 256, BK = 64, HALF = 128, HTB = HALF * BK * 2, STAGE_BYTES = 8 * HTB, NXCD = 8, WGM = 8;
__host__ __device__ __forceinline__ int lds_byte(int r, int c) { const int st = (r >> 4) * 2 + (c >> 5), rr = r & 15, cc = c & 31, ob = rr * 64 + cc * 2; return st * 1024 + (ob ^ (((ob >> 9) & 1) << 5)); }
__host__ __device__ __forceinline__ void stage_rc(int b, int& R, int& C) { const int st = b / 1024, sb = b % 1024, swz = sb ^ (((sb >> 9) & 1) << 5); R = (st >> 1) * 16 + swz / 64; C = (st & 1) * 32 + (swz % 64) / 2; }
__host__ __device__ __forceinline__ int perm32(int rho) { const int n = rho >> 4, i = rho & 15; return 8 * (i >> 2) + 4 * n + (i & 3); }

struct UnitD { int kind, pm, pn; };
struct GemmK { const char* A; const char* B; int K; };

__device__ __forceinline__ void map_unit(int L, int nM, int nN, int& pm, int& pn) {
    const int nwg = nM * nN; int wgid = L;
    { const int q = nwg / NXCD, r = nwg % NXCD, xcd = wgid % NXCD, off = wgid / NXCD; wgid = (xcd < r ? xcd * (q + 1) : r * (q + 1) + (xcd - r) * q) + off; }
    const int nig = WGM * nN, gid = wgid / nig, fm = gid * WGM, gsz = (nM - fm) < WGM ? (nM - fm) : WGM;
    pm = fm + ((wgid % nig) % gsz); pn = (wgid % nig) / gsz;
}

template <class Sched, class Ctx>
__device__ __forceinline__ void gemm_stream(LAS unsigned char* lds, const Sched& S, const Ctx& X) {
    const int tid = threadIdx.x, wid = __builtin_amdgcn_readfirstlane(tid >> 6), lane = tid & 63, wr = wid >> 2, wc = wid & 3, fr = lane & 15, fq = lane >> 4;
    unsigned RA2[2], RB2[2], CC2[2];
#pragma unroll
    for (int i = 0; i < 2; ++i) { int R, C; stage_rc(tid * 16 + i * 8192, R, C); RA2[i] = (unsigned)R * 2u; RB2[i] = (unsigned)((R & ~31) + perm32(R & 31)) * 2u; CC2[i] = (unsigned)C * 2u; }
    const unsigned ldsw = (unsigned)wid * 1024u;
    const int aoff = lds_byte(wr * 64 + fr, fq * 8), boff = lds_byte(wc * 32 + fr, fq * 8);
#define PG8_SA(b, h) (((b) * 2 + (h)) * HTB)
#define PG8_SB(b, h) ((4 + (b) * 2 + (h)) * HTB)
#define PG8_STAGE(bufoff, gbase, R2, Kv) do { _Pragma("unroll") for (int _i = 0; _i < 2; ++_i) \
        __builtin_amdgcn_global_load_lds((const unsigned*)((const char*)(gbase) + (R2[_i] * (unsigned)(Kv) + CC2[_i])), (LAS unsigned*)(lds + (bufoff) + ldsw + _i * 8192), 16, 0, 0); } while (0)
#define PG8_LDA(dst, b, h) do { _Pragma("unroll") for (int m = 0; m < 4; ++m) _Pragma("unroll") for (int k = 0; k < 2; ++k) dst[m][k] = *(const LAS bf16x8*)(lds + PG8_SA(b, h) + aoff + m * 2048 + k * 1024); } while (0)
#define PG8_LDB(dst, b, h) do { _Pragma("unroll") for (int n = 0; n < 2; ++n) _Pragma("unroll") for (int k = 0; k < 2; ++k) dst[n][k] = *(const LAS bf16x8*)(lds + PG8_SB(b, h) + boff + n * 2048 + k * 1024); } while (0)
#define PG8_MMA(ai, bj, At, Bt) do { __builtin_amdgcn_s_setprio(1); _Pragma("unroll") for (int m = 0; m < 4; ++m) _Pragma("unroll") for (int n = 0; n < 2; ++n) _Pragma("unroll") for (int k = 0; k < 2; ++k) \
        acc[ai][bj][m][n] = __builtin_amdgcn_mfma_f32_16x16x32_bf16(Bt[n][k], At[m][k], acc[ai][bj][m][n], 0, 0, 0); __builtin_amdgcn_s_setprio(0); } while (0)
#define PG8_WAIT_V(n) asm volatile("s_waitcnt vmcnt(" #n ")" ::: "memory")
#define PG8_WAIT_L(n) asm volatile("s_waitcnt lgkmcnt(" #n ")" ::: "memory")
#define PG8_BAR __builtin_amdgcn_s_barrier()
#define PG8_SCHED __builtin_amdgcn_sched_barrier(0)
    UnitD cur, nxt; int ui = 0;
    if (!S.next(0, cur)) return;
    f32x4 acc[2][2][4][2];
#pragma unroll
    for (int a = 0; a < 2; ++a)
#pragma unroll
        for (int b = 0; b < 2; ++b)
#pragma unroll
            for (int m = 0; m < 4; ++m)
#pragma unroll
                for (int n = 0; n < 2; ++n) acc[a][b][m][n] = (f32x4){0.f, 0.f, 0.f, 0.f};
    bf16x8 At[4][2], B0[2][2], B1[2][2];
    int Kc; const char* cA; const char* cB;
    { const GemmK g0 = X.gemm(cur.kind); Kc = g0.K; cA = g0.A + (size_t)cur.pm * (size_t)(512 * Kc); cB = g0.B + (size_t)cur.pn * (size_t)(512 * Kc); }
    S.a_ready(cur);
    {   const size_t hs = (size_t)256 * Kc;
        PG8_STAGE(PG8_SB(0, 0), cB, RB2, Kc); PG8_STAGE(PG8_SB(0, 1), cB + hs, RB2, Kc); PG8_STAGE(PG8_SA(0, 0), cA, RA2, Kc); PG8_STAGE(PG8_SA(0, 1), cA + hs, RA2, Kc);
        if (wr == 1) PG8_BAR;
        PG8_WAIT_V(2); PG8_BAR;
        PG8_STAGE(PG8_SB(1, 0), cB + 128, RB2, Kc); PG8_STAGE(PG8_SA(1, 0), cA + 128, RA2, Kc); PG8_STAGE(PG8_SB(1, 1), cB + hs + 128, RB2, Kc);
        PG8_WAIT_V(6); PG8_BAR;
    }
    for (;;) {
        const bool has_next = S.next(ui + 1, nxt);
        int Kn = Kc; const char* nA = cA; const char* nB = cB;
        if (has_next) { const GemmK gn = X.gemm(nxt.kind); Kn = gn.K; nA = gn.A + (size_t)nxt.pm * (size_t)(512 * Kn); nB = gn.B + (size_t)nxt.pn * (size_t)(512 * Kn); }
        const int nt = Kc / BK; const size_t hsc = (size_t)256 * Kc;
        for (int t = 0; t < nt; t += 2) {
            const bool last = (t == nt - 2);
            const char* a1 = cA + (size_t)(t + 1) * 128;
            const int K2 = last ? Kn : Kc; const size_t hs2 = (size_t)256 * K2;
            const char* a2 = last ? nA : cA + (size_t)(t + 2) * 128; const char* b2 = last ? nB : cB + (size_t)(t + 2) * 128;
            const char* a3 = a2 + 128; const char* b3 = b2 + 128;
            if (last && has_next) S.a_ready(nxt);
            PG8_LDB(B0, 0, 0); PG8_LDB(B1, 0, 1); PG8_SCHED; PG8_LDA(At, 0, 0); PG8_STAGE(PG8_SA(1, 1), a1 + hsc, RA2, Kc);
            PG8_WAIT_V(8); PG8_WAIT_L(0); PG8_BAR; PG8_MMA(0, 0, At, B0); PG8_MMA(0, 1, At, B1); PG8_BAR; PG8_SCHED;
            PG8_LDA(At, 0, 1); PG8_STAGE(PG8_SB(0, 0), b2, RB2, K2); PG8_STAGE(PG8_SB(0, 1), b2 + hs2, RB2, K2); PG8_STAGE(PG8_SA(0, 0), a2, RA2, K2);
            PG8_WAIT_V(8); PG8_WAIT_L(0); PG8_BAR; PG8_MMA(1, 0, At, B0); PG8_MMA(1, 1, At, B1); PG8_BAR; PG8_SCHED;
            PG8_LDB(B0, 1, 0); PG8_LDB(B1, 1, 1); PG8_SCHED; PG8_LDA(At, 1, 0); PG8_STAGE(PG8_SA(0, 1), a2 + hs2, RA2, K2);
            PG8_WAIT_V(8); PG8_WAIT_L(0); PG8_BAR; PG8_MMA(0, 0, At, B0); PG8_MMA(0, 1, At, B1); PG8_BAR; PG8_SCHED;
            PG8_LDA(At, 1, 1); PG8_STAGE(PG8_SB(1, 0), b3, RB2, K2); PG8_STAGE(PG8_SB(1, 1), b3 + hs2, RB2, K2); PG8_STAGE(PG8_SA(1, 0), a3, RA2, K2);
            PG8_WAIT_V(8); PG8_WAIT_L(0); PG8_BAR; PG8_MMA(1, 0, At, B0); PG8_MMA(1, 1, At, B1); PG8_BAR; PG8_SCHED;
        }
        if (wr == 0) PG8_BAR;
        X.epilogue(acc, cur, wr, wc, fr, fq); S.done(cur);
        if (!has_next) break;
#pragma unroll
        for (int a = 0; a < 2; ++a)
#pragma unroll
            for (int b = 0; b < 2; ++b)
#pragma unroll
                for (int m = 0; m < 4; ++m)
#pragma unroll
                    for (int n = 0; n < 2; ++n) acc[a][b][m][n] = (f32x4){0.f, 0.f, 0.f, 0.f};
        cur = nxt; cA = nA; cB = nB; Kc = Kn; ++ui;
        if (wr == 1) PG8_BAR;
    }
    PG8_WAIT_V(0);
    PG8_BAR;
#undef PG8_SA
#undef PG8_SB
#undef PG8_STAGE
#undef PG8_LDA
#undef PG8_LDB
#undef PG8_MMA
#undef PG8_WAIT_V
#undef PG8_WAIT_L
#undef PG8_BAR
#undef PG8_SCHED
}
}
using pg8::UnitD; using pg8::GemmK;
typedef const f32x4 (&AccRef)[2][2][4][2];

#define XB_TMO      128
#define XB_XCNT(j)  (256  + 64 * (j))
#define XB_XSUB(j)  (1280 + 64 * (j))
#define XB_XGEN(j)  (2304 + 64 * (j))
#define XB_TOP      3328
#define XB_TOPGEN   3392
#define XCD_BAR_WORDS 3456
#define XB_SPIN_CAP (1u << 18)
__device__ __forceinline__ unsigned xb_ld(unsigned* p)              { return __hip_atomic_load(p, __ATOMIC_RELAXED, __HIP_MEMORY_SCOPE_AGENT); }
__device__ __forceinline__ unsigned xb_add(unsigned* p, unsigned v) { return __hip_atomic_fetch_add(p, v, __ATOMIC_RELAXED, __HIP_MEMORY_SCOPE_AGENT); }
__device__ __forceinline__ unsigned xb_xcc_id() { return (unsigned)__builtin_amdgcn_s_getreg((3 << 11) | 20) & 0xFu; }
#define XB_SPIN(cond, bar) do { unsigned _sp = 0; while (cond) { __builtin_amdgcn_s_sleep(1); \
    if ((++_sp & 255u) == 0u) { if (xb_ld(&(bar)[XB_TMO])) break; if (_sp > XB_SPIN_CAP) { atomicAdd(&(bar)[XB_TMO], 1u); break; } } } } while (0)
struct XcdBarrier { unsigned* bar; unsigned x; volatile LAS unsigned* st; };
__device__ __forceinline__ XcdBarrier xcd_barrier_post(unsigned* bar, volatile LAS unsigned* st) {
    XcdBarrier b; b.bar = bar; b.x = xb_xcc_id(); b.st = st;
    if (threadIdx.x == 0) (void)xb_add(&bar[XB_XCNT(b.x)], 1u);
    return b;
}
__device__ __forceinline__ void xcd_barrier_complete(unsigned* bar, unsigned x, unsigned& nloc, unsigned& nx) {
    const unsigned G = gridDim.x * gridDim.y * gridDim.z;
    unsigned sum, cnt, mine, sp = 0u;
    for (;;) {
        sum = 0u; cnt = 0u; mine = 0u;
#pragma unroll
        for (unsigned j = 0; j < 16; ++j) { const unsigned c = xb_ld(&bar[XB_XCNT(j)]); sum += c; cnt += (c > 0u) ? 1u : 0u; mine = (j == x) ? c : mine; }
        if (sum == G) break;
        __builtin_amdgcn_s_sleep(1);
        if ((++sp & 255u) == 0u) { if (xb_ld(&bar[XB_TMO])) break; if (sp > XB_SPIN_CAP) { atomicAdd(&bar[XB_TMO], 1u); break; } }
    }
    nloc = mine > 0u ? mine : 1u; nx = cnt > 0u ? cnt : 1u;
}
__device__ __forceinline__ void xcd_barrier(const XcdBarrier& b) {
    asm volatile("s_waitcnt vmcnt(0)" ::: "memory");
    __syncthreads();
    if (threadIdx.x == 0) {
        unsigned* bar = b.bar;
        __builtin_amdgcn_s_waitcnt(0);
        unsigned nloc = b.st[0], nx = b.st[1];
        if (nloc == 0u) { xcd_barrier_complete(bar, b.x, nloc, nx); b.st[0] = nloc; b.st[1] = nx; }
        const unsigned old = xb_add(&bar[XB_XSUB(b.x)], 1u);
        const unsigned gen = old / nloc;
        if (old + 1u == (gen + 1u) * nloc) {
            __builtin_amdgcn_fence(__ATOMIC_RELEASE, "agent");
            asm volatile("s_waitcnt vmcnt(0)" ::: "memory");
            const unsigned og = xb_add(&bar[XB_TOP], 1u);
            const unsigned tg = og / nx;
            if (og + 1u == (tg + 1u) * nx) xb_add(&bar[XB_TOPGEN], 1u);
            else XB_SPIN(xb_ld(&bar[XB_TOPGEN]) == tg, bar);
            __builtin_amdgcn_fence(__ATOMIC_ACQUIRE, "agent");
            xb_add(&bar[XB_XGEN(b.x)], 1u);
            asm volatile("s_waitcnt vmcnt(0)" ::: "memory");
        } else {
            XB_SPIN(xb_ld(&bar[XB_XGEN(b.x)]) == gen, bar);
            __builtin_amdgcn_fence(__ATOMIC_ACQUIRE, "agent");
            asm volatile("s_waitcnt vmcnt(0)" ::: "memory");
        }
    }
    __syncthreads();
}

struct Args { const float* in[23]; float* out; unsigned char* ws; int ph_lo, ph_hi, li, pad; };
enum { I_XP = 0, I_XS, I_PP, I_PS, I_SC, I_SN, I_SM, I_SCV, I_GMIX, I_WIN, I_BIG, I_BFG, I_GMH, I_CONVW, I_WOUT, I_GFFN, I_WGATE, I_WUP, I_WDOWN, I_WPLE, I_GPLE, I_WPG, I_GFINAL };

__device__ __forceinline__ void p0_tr_item(const float* W, int src_ld, int src_c0, bf16_t* WT, int K, int drow0, int k0, float sc, const float* gk, LAS float* scr, int lane) {
#pragma unroll 8
    for (int i = 0; i < 32; ++i) { const int kk = 2 * i + (lane >> 5); const float g = gk ? gk[k0 + kk] * sc : sc;
        scr[kk * 33 + (lane & 31)] = W[(size_t)(k0 + kk) * src_ld + src_c0 + (lane & 31)] * g; }
    LDS_WAIT(); asm volatile("" ::: "memory");
    const int c = lane & 7;
#pragma unroll
    for (int j = 0; j < 4; ++j) { const int n = (lane >> 3) + 8 * j; const LAS float* s = scr + (8 * c) * 33 + n;
        u32x4 o; o.x = pk2(s[0 * 33], s[1 * 33]); o.y = pk2(s[2 * 33], s[3 * 33]); o.z = pk2(s[4 * 33], s[5 * 33]); o.w = pk2(s[6 * 33], s[7 * 33]);
        *(u32x4*)(WT + (size_t)(drow0 + n) * K + k0 + 8 * c) = o; }
    LDS_WAIT(); asm volatile("" ::: "memory");
}

__device__ __forceinline__ void p0_prologue(const Args& a, LAS unsigned char* lds, int vcu, int G) {
    const int tid = threadIdx.x, lane = tid & 63, wave = __builtin_amdgcn_readfirstlane(tid >> 6);
    unsigned char* ws = a.ws;
    const int gw = vcu * 8 + wave, NGW = G * 8;
    LAS float* gwl = (LAS float*)(lds + 98304);
    { const float* win = a.in[I_WIN];
      for (int i = tid; i < 1024 * 8; i += 512) gwl[i] = win[(size_t)(i >> 3) * PROJ + 1024 + (i & 7)]; }
    __syncthreads();
    {
        bf16_t* XN = (bf16_t*)(ws + WS_R1); bf16_t* PB = (bf16_t*)(ws + WS_PB); float* GT = (float*)(ws + WS_GATES);
        const float* gmix = a.in[I_GMIX];
        f32x4 gm[4];
#pragma unroll
        for (int j = 0; j < 4; ++j) gm[j] = *(const f32x4*)(gmix + 4 * lane + 256 * j);
        for (int m = gw; m < TT; m += NGW) {
            const float* xrow = (m < TP) ? a.in[I_XP] + (size_t)m * DM : a.in[I_XS] + (size_t)(m - TP) * DM;
            const float* prow = (m < TP) ? a.in[I_PP] + (size_t)m * PLE : a.in[I_PS] + (size_t)(m - TP) * PLE;
            f32x4 v[4]; float s = 0.f;
#pragma unroll
            for (int j = 0; j < 4; ++j) { v[j] = *(const f32x4*)(xrow + 4 * lane + 256 * j); s += (v[j].x * v[j].x + v[j].y * v[j].y) + (v[j].z * v[j].z + v[j].w * v[j].w); }
            const f32x4 pv = *(const f32x4*)(prow + 4 * lane);
            const float rs = 1.0f / sqrtf(wave_sum(s) * (1.f / DM) + EPS);
            float gacc[8];
#pragma unroll
            for (int c = 0; c < 8; ++c) gacc[c] = 0.f;
#pragma unroll
            for (int j = 0; j < 4; ++j) {
                v[j] = v[j] * rs * gm[j];
                u32x2 o; o.x = pk2(v[j].x, v[j].y); o.y = pk2(v[j].z, v[j].w);
                *(u32x2*)(XN + (size_t)m * DM + 4 * lane + 256 * j) = o;
#pragma unroll
                for (int e = 0; e < 4; ++e) { const int k = 4 * lane + 256 * j + e; const f32x4 w0 = *(const LAS f32x4*)(gwl + k * 8), w1 = *(const LAS f32x4*)(gwl + k * 8 + 4);
                    const float xv = v[j][e];
                    gacc[0] += xv * w0.x; gacc[1] += xv * w0.y; gacc[2] += xv * w0.z; gacc[3] += xv * w0.w;
                    gacc[4] += xv * w1.x; gacc[5] += xv * w1.y; gacc[6] += xv * w1.z; gacc[7] += xv * w1.w; }
            }
#pragma unroll
            for (int c = 0; c < 8; ++c) gacc[c] = wave_sum(gacc[c]);
            if (lane < 8) {
                float pre = gacc[0];
#pragma unroll
                for (int c = 1; c < 8; ++c) pre = (lane == c) ? gacc[c] : pre;
                float o;
                if (lane < 4) { const float z = pre + a.in[I_BIG][lane]; o = GATE_CAP * tanhf(z * (1.0f / GATE_CAP)); }
                else { const float z = pre + a.in[I_BFG][lane - 4]; o = fminf(z, 0.f) - log1pf(__expf(-fabsf(z))); }
                GT[(size_t)m * 8 + lane] = o;
            }
            { u32x2 o; o.x = pk2(pv.x, pv.y); o.y = pk2(pv.z, pv.w); *(u32x2*)(PB + (size_t)m * PLE + 4 * lane) = o; }
        }
    }
    {
        LAS float* scr = (LAS float*)(lds + wave * 8448);
        constexpr int I_IN = 16 * 96, I_OUT = 16 * 32, I_GU = 16 * 176, I_DN = 44 * 32, I_PL = 4 * 32, I_PG = 16 * 32;
        constexpr int NITEMS = I_IN + I_OUT + I_GU + I_DN + I_PL + I_PG;
        for (int it = gw; it < NITEMS; it += NGW) {
            int r = it;
            if (r < I_IN) { const int kb = r / 96, nb = r % 96, n0 = nb * 32; const int sc0 = n0 < 1024 ? n0 : n0 + 8;
                p0_tr_item(a.in[I_WIN], PROJ, sc0, (bf16_t*)(ws + WS_WIN), 1024, n0, kb * 64, n0 < 256 ? 0.125f : 1.0f, nullptr, scr, lane); continue; } r -= I_IN;
            if (r < I_OUT) { const int kb = r / 32, nb = r % 32; p0_tr_item(a.in[I_WOUT], DM, nb * 32, (bf16_t*)(ws + WS_WOUT), 1024, nb * 32, kb * 64, 1.0f, nullptr, scr, lane); continue; } r -= I_OUT;
            if (r < I_GU) { const int kb = r / 176, nb = r % 176, n0 = nb * 32, pn = n0 >> 8, c = n0 & 255;
                const float* src = c < 128 ? a.in[I_WGATE] : a.in[I_WUP]; const int sc0 = pn * 128 + (c & 127);
                p0_tr_item(src, DFF, sc0, (bf16_t*)(ws + WS_WGU), 1024, n0, kb * 64, 1.0f, a.in[I_GFFN], scr, lane); continue; } r -= I_GU;
            if (r < I_DN) { const int kb = r / 32, nb = r % 32; p0_tr_item(a.in[I_WDOWN], DM, nb * 32, (bf16_t*)(ws + WS_WDOWN), DFF, nb * 32, kb * 64, 1.0f, nullptr, scr, lane); continue; } r -= I_DN;
            if (r < I_PL) { const int kb = r / 32, nb = r % 32; p0_tr_item(a.in[I_WPLE], DM, nb * 32, (bf16_t*)(ws + WS_WPLE), PLE, nb * 32, kb * 64, 1.0f, nullptr, scr, lane); continue; } r -= I_PL;
            { const int kb = r / 32, nb = r % 32; p0_tr_item(a.in[I_WPG], DM, nb * 32, (bf16_t*)(ws + WS_WPG), 1024, nb * 32, kb * 64, 1.0f, nullptr, scr, lane); }
        }
    }
}

__device__ __forceinline__ u32x4 pack8(const f32x4 v0, const f32x4 v1) { u32x4 w; w.x = cvt_pk_bf16(v0[0], v0[1]); w.y = cvt_pk_bf16(v0[2], v0[3]); w.z = cvt_pk_bf16(v1[0], v1[1]); w.w = cvt_pk_bf16(v1[2], v1[3]); return w; }
__device__ __forceinline__ float sq8(const f32x4 a, const f32x4 b) { return ((a[0] * a[0] + a[1] * a[1]) + (a[2] * a[2] + a[3] * a[3])) + ((b[0] * b[0] + b[1] * b[1]) + (b[2] * b[2] + b[3] * b[3])); }
__device__ __forceinline__ float row_rs(const float* ssq, int row) {
    const f32x4 p0 = *(const f32x4*)(ssq + (size_t)row * 16), p1 = *(const f32x4*)(ssq + (size_t)row * 16 + 4), p2 = *(const f32x4*)(ssq + (size_t)row * 16 + 8), p3 = *(const f32x4*)(ssq + (size_t)row * 16 + 12);
    const f32x4 s = (p0 + p1) + (p2 + p3);
    return 1.0f / sqrtf(((s[0] + s[1]) + (s[2] + s[3])) * (1.f / DM) + EPS);
}

__device__ __forceinline__ void epi_bf16(AccRef acc, const UnitD& u, int wr, int wc, int fr, int fq, bf16_t* O, int ldc) {
    const int row0 = u.pm * 256 + wr * 64 + fr, col0 = u.pn * 256 + wc * 32 + 8 * fq;
#pragma unroll
    for (int ai = 0; ai < 2; ++ai)
#pragma unroll
        for (int m = 0; m < 4; ++m) { bf16_t* rowp = O + (size_t)(row0 + ai * 128 + m * 16) * ldc + col0;
#pragma unroll
            for (int bj = 0; bj < 2; ++bj) *(u32x4*)(rowp + bj * 128) = pack8(acc[ai][bj][m][0], acc[ai][bj][m][1]); }
}
__device__ __forceinline__ void epi_bf16_ssq(AccRef acc, const UnitD& u, int wr, int wc, int fr, int fq, bf16_t* O, int ldc, float* ssq) {
    const int row0 = u.pm * 256 + wr * 64 + fr, col0 = u.pn * 256 + wc * 32 + 8 * fq;
#pragma unroll
    for (int ai = 0; ai < 2; ++ai)
#pragma unroll
        for (int m = 0; m < 4; ++m) { const int row = row0 + ai * 128 + m * 16; bf16_t* rowp = O + (size_t)row * ldc + col0; float s = 0.f;
#pragma unroll
            for (int bj = 0; bj < 2; ++bj) { *(u32x4*)(rowp + bj * 128) = pack8(acc[ai][bj][m][0], acc[ai][bj][m][1]); s += sq8(acc[ai][bj][m][0], acc[ai][bj][m][1]); }
            s += __shfl_xor(s, 16); s += __shfl_xor(s, 32);
            if (fq == 0) ssq[(size_t)row * 16 + u.pn * 4 + wc] = s; }
}
template <bool SSQ>
__device__ __forceinline__ void epi_resid(AccRef acc, const UnitD& u, int wr, int wc, int fr, int fq, const float* base, float* Y, bf16_t* XB, float* ssq) {
    const int row0 = u.pm * 256 + wr * 64 + fr, col0 = u.pn * 256 + wc * 32 + 8 * fq;
#pragma unroll
    for (int ai = 0; ai < 2; ++ai)
#pragma unroll
        for (int m = 0; m < 4; ++m) { const int row = row0 + ai * 128 + m * 16; const size_t off = (size_t)row * DM + col0; float s = 0.f;
#pragma unroll
            for (int bj = 0; bj < 2; ++bj) {
                const f32x4 b0 = *(const f32x4*)(base + off + bj * 128), b1 = *(const f32x4*)(base + off + bj * 128 + 4);
                const f32x4 v0 = b0 + acc[ai][bj][m][0], v1 = b1 + acc[ai][bj][m][1];
                *(f32x4*)(Y + off + bj * 128) = v0; *(f32x4*)(Y + off + bj * 128 + 4) = v1;
                *(u32x4*)(XB + off + bj * 128) = pack8(v0, v1);
                if (SSQ) s += sq8(v0, v1); }
            if (SSQ) { s += __shfl_xor(s, 16); s += __shfl_xor(s, 32); if (fq == 0) ssq[(size_t)row * 16 + u.pn * 4 + wc] = s; }
            if (m & 1) asm volatile("" ::: "memory"); }
}
__device__ __forceinline__ void epi_swiglu(AccRef acc, const UnitD& u, int wr, int wc, int fr, int fq, const float* ssq, bf16_t* ACT) {
    const int row0 = u.pm * 256 + wr * 64 + fr, col0 = u.pn * 128 + wc * 32 + 8 * fq;
#pragma unroll
    for (int ai = 0; ai < 2; ++ai)
#pragma unroll
        for (int m = 0; m < 4; ++m) { const int row = row0 + ai * 128 + m * 16; const float rs = row_rs(ssq, row);
            f32x4 o[2];
#pragma unroll
            for (int n = 0; n < 2; ++n)
#pragma unroll
                for (int e = 0; e < 4; ++e) { const float g = acc[ai][0][m][n][e] * rs, up = acc[ai][1][m][n][e] * rs; o[n][e] = g * sigmoidf_(g) * up; }
            *(u32x4*)(ACT + (size_t)row * DFF + col0) = pack8(o[0], o[1]); }
}
__device__ __forceinline__ void epi_plegate(AccRef acc, const UnitD& u, int wr, int wc, int fr, int fq, float* Y, const bf16_t* E, const float* ssqe, const float* gple, float* ssq3) {
    const int row0 = u.pm * 256 + wr * 64 + fr, col0 = u.pn * 256 + wc * 32 + 8 * fq;
    f32x4 gp[2][2];
#pragma unroll
    for (int bj = 0; bj < 2; ++bj) { gp[bj][0] = *(const f32x4*)(gple + col0 + bj * 128); gp[bj][1] = *(const f32x4*)(gple + col0 + bj * 128 + 4); }
#pragma unroll
    for (int ai = 0; ai < 2; ++ai)
#pragma unroll
        for (int m = 0; m < 4; ++m) { const int row = row0 + ai * 128 + m * 16; const size_t off = (size_t)row * DM + col0; const float rse = row_rs(ssqe, row); float s = 0.f;
#pragma unroll
            for (int bj = 0; bj < 2; ++bj) {
                const f32x4 b0 = *(const f32x4*)(Y + off + bj * 128), b1 = *(const f32x4*)(Y + off + bj * 128 + 4);
                const u32x4 ew = *(const u32x4*)(E + off + bj * 128);
                const f32x4 e0 = (f32x4){bf_lo(ew.x), bf_hi(ew.x), bf_lo(ew.y), bf_hi(ew.y)} * rse * gp[bj][0];
                const f32x4 e1 = (f32x4){bf_lo(ew.z), bf_hi(ew.z), bf_lo(ew.w), bf_hi(ew.w)} * rse * gp[bj][1];
                f32x4 v0, v1;
#pragma unroll
                for (int e = 0; e < 4; ++e) { v0[e] = b0[e] + sigmoidf_(acc[ai][bj][m][0][e]) * e0[e]; v1[e] = b1[e] + sigmoidf_(acc[ai][bj][m][1][e]) * e1[e]; }
                *(f32x4*)(Y + off + bj * 128) = v0; *(f32x4*)(Y + off + bj * 128 + 4) = v1;
                s += sq8(v0, v1); }
            s += __shfl_xor(s, 16); s += __shfl_xor(s, 32); if (fq == 0) ssq3[(size_t)row * 16 + u.pn * 4 + wc] = s;
            asm volatile("" ::: "memory"); }
}

enum { K_IN = 0, K_OUT, K_GU, K_DOWN, K_PLE, K_PG };
struct SchedOne {
    int kind, nM, nN, total, G, c;
    __device__ __forceinline__ bool next(int i, UnitD& u) const { const int L = i * G + c; if (L >= total) return false; u.kind = kind; pg8::map_unit(L, nM, nN, u.pm, u.pn); return true; }
    __device__ __forceinline__ void a_ready(const UnitD&) const {}
    __device__ __forceinline__ void done(const UnitD&) const {}
};
struct SchedP3 {
    int G, c;
    __device__ __forceinline__ bool next(int i, UnitD& u) const {
        int L = i * G + c;
        if (G == 256 && i == 2) { if (c < 8 || c >= 24) return false; L = 512 + (c - 8); }
        if (L >= 2 * NPAN * 4) return false;
        if (L < NPAN * 4) { u.kind = K_OUT; pg8::map_unit(L, NPAN, 4, u.pm, u.pn); } else { u.kind = K_PLE; pg8::map_unit(L - NPAN * 4, NPAN, 4, u.pm, u.pn); }
        return true; }
    __device__ __forceinline__ void a_ready(const UnitD&) const {}
    __device__ __forceinline__ void done(const UnitD&) const {}
};
struct Ctx {
    const Args* a; unsigned char* ws;
    __device__ __forceinline__ GemmK gemm(int kind) const {
        GemmK g;
        if (kind == K_IN)        { g.A = (const char*)(ws + WS_R1); g.B = (const char*)(ws + WS_WIN);   g.K = 1024; }
        else if (kind == K_OUT)  { g.A = (const char*)(ws + WS_R2); g.B = (const char*)(ws + WS_WOUT);  g.K = 1024; }
        else if (kind == K_GU)   { g.A = (const char*)(ws + WS_R1); g.B = (const char*)(ws + WS_WGU);   g.K = 1024; }
        else if (kind == K_DOWN) { g.A = (const char*)(ws + WS_U);  g.B = (const char*)(ws + WS_WDOWN); g.K = DFF; }
        else if (kind == K_PLE)  { g.A = (const char*)(ws + WS_PB); g.B = (const char*)(ws + WS_WPLE);  g.K = PLE; }
        else                     { g.A = (const char*)(ws + WS_R1); g.B = (const char*)(ws + WS_WPG);   g.K = 1024; }
        return g;
    }
    __device__ __forceinline__ void epilogue(AccRef acc, const UnitD& u, int wr, int wc, int fr, int fq) const {
        float* Y = a->out + OUT_Y;
        if (u.kind == K_IN) epi_bf16(acc, u, wr, wc, fr, fq, (bf16_t*)(ws + WS_U), NU);
        else if (u.kind == K_OUT) { const float* base = (u.pm < 64) ? a->in[I_XP] : a->in[I_XS] - (size_t)TP * DM;
            epi_resid<true>(acc, u, wr, wc, fr, fq, base, Y, (bf16_t*)(ws + WS_R1), (float*)(ws + WS_SSQ1)); }
        else if (u.kind == K_GU) epi_swiglu(acc, u, wr, wc, fr, fq, (const float*)(ws + WS_SSQ1), (bf16_t*)(ws + WS_U));
        else if (u.kind == K_DOWN) epi_resid<false>(acc, u, wr, wc, fr, fq, Y, Y, (bf16_t*)(ws + WS_R1), nullptr);
        else if (u.kind == K_PLE) epi_bf16_ssq(acc, u, wr, wc, fr, fq, (bf16_t*)(ws + WS_E), DM, (float*)(ws + WS_SSQE));
        else epi_plegate(acc, u, wr, wc, fr, fq, Y, (const bf16_t*)(ws + WS_E), (const float*)(ws + WS_SSQE), a->in[I_GPLE], (float*)(ws + WS_SSQ3));
    }
};

constexpr int PK = 144, PV = 304;
__device__ __forceinline__ bf16x8 tr_frag(const LAS unsigned char* base, int pitch, int row0, int col0, int lane) {
    const int g = lane >> 4, q = (lane & 15) >> 2, p = lane & 3;
    const LAS unsigned char* ad = base + (row0 + 8 * g + q) * pitch + (col0 + 4 * p) * 2;
    const s16x4 lo = __builtin_amdgcn_ds_read_tr16_b64_v4i16((LAS s16x4*)ad);
    const s16x4 hi = __builtin_amdgcn_ds_read_tr16_b64_v4i16((LAS s16x4*)(ad + 4 * pitch));
    return (bf16x8){lo[0], lo[1], lo[2], lo[3], hi[0], hi[1], hi[2], hi[3]};
}
__device__ __forceinline__ bf16x8 row_frag(const LAS unsigned char* base, int pitch, int row0, int k0, int lane) {
    return *(const LAS bf16x8*)(base + (row0 + (lane & 15)) * pitch + (k0 + 8 * (lane >> 4)) * 2);
}

__device__ __forceinline__ void mlstm_A_item(unsigned char* ws, int item, LAS unsigned char* L, int ht, int hw, int lane) {
    const int bh = item >> 5, c = item & 31, b = bh >> 2, h = bh & 3, row0 = b * 2048 + c * 64;
    const bf16_t* U = (const bf16_t*)(ws + WS_U); const float* GT = (const float*)(ws + WS_GATES);
    LAS unsigned char* wkk = L; LAS unsigned char* vt = L + 64 * PK;
    const float lf = GT[(size_t)(row0 + lane) * 8 + 4 + h], ig = GT[(size_t)(row0 + lane) * 8 + h];
    const float bc = wave_incl_scan(lf, lane), bL = __shfl(bc, 63), d = bL - bc + ig, wk = __expf(d), mloc = wave_max(d);
    if (hw == 0 && lane == 0) { ((float*)(ws + WS_BL))[item] = bL; ((float*)(ws + WS_MLOC))[item] = mloc; }
    {   const int s = ht >> 2, part = ht & 3; const float wks = __shfl(wk, (s & 15) + 16 * hw);
        const u32x4* src = (const u32x4*)(U + (size_t)(row0 + s) * NU + 256 + h * 64 + part * 16);
        const u32x4 k0 = src[0], k1 = src[1]; u32x4 o0, o1;
        o0.x = pk2(bf_lo(k0.x) * wks, bf_hi(k0.x) * wks); o0.y = pk2(bf_lo(k0.y) * wks, bf_hi(k0.y) * wks); o0.z = pk2(bf_lo(k0.z) * wks, bf_hi(k0.z) * wks); o0.w = pk2(bf_lo(k0.w) * wks, bf_hi(k0.w) * wks);
        o1.x = pk2(bf_lo(k1.x) * wks, bf_hi(k1.x) * wks); o1.y = pk2(bf_lo(k1.y) * wks, bf_hi(k1.y) * wks); o1.z = pk2(bf_lo(k1.z) * wks, bf_hi(k1.z) * wks); o1.w = pk2(bf_lo(k1.w) * wks, bf_hi(k1.w) * wks);
        *(LAS u32x4*)(wkk + s * PK + part * 32) = o0; *(LAS u32x4*)(wkk + s * PK + part * 32 + 16) = o1; }
#pragma unroll
    for (int i = 0; i < 4; ++i) { const int idx = ht + 256 * i, s = idx >> 4, ch = idx & 15;
        *(LAS u32x4*)(vt + s * PV + ch * 16) = *(const u32x4*)(U + (size_t)(row0 + s) * NU + 512 + h * 128 + ch * 8); }
    if (ht < 64) { *(LAS u32x4*)(vt + ht * PV + 256) = (u32x4){0x3F80u, 0u, 0u, 0u}; *(LAS u32x4*)(vt + ht * PV + 272) = (u32x4){0u, 0u, 0u, 0u}; }
    __syncthreads();
    float* UT = (float*)(ws + WS_R1) + (size_t)item * (DV * DK); float* UN = (float*)(ws + WS_UN) + (size_t)item * DK;
    const int g = lane >> 4, fr = lane & 15;
    bf16x8 bk[4][2];
#pragma unroll
    for (int kb = 0; kb < 4; ++kb)
#pragma unroll
        for (int ks = 0; ks < 2; ++ks) bk[kb][ks] = tr_frag(wkk, PK, ks * 32, kb * 16, lane);
    const int nblk = (hw == 0) ? 3 : 2;
    for (int bi = 0; bi < nblk; ++bi) {
        const int db = (bi == 2) ? 8 : 2 * hw + bi;
        const bf16x8 a0 = tr_frag(vt, PV, 0, db * 16, lane), a1 = tr_frag(vt, PV, 32, db * 16, lane);
#pragma unroll
        for (int kb = 0; kb < 4; ++kb) {
            f32x4 acc = (f32x4){0.f, 0.f, 0.f, 0.f};
            acc = __builtin_amdgcn_mfma_f32_16x16x32_bf16(a0, bk[kb][0], acc, 0, 0, 0);
            acc = __builtin_amdgcn_mfma_f32_16x16x32_bf16(a1, bk[kb][1], acc, 0, 0, 0);
            if (db < 8) {
#pragma unroll
                for (int r = 0; r < 4; ++r) UT[(db * 16 + 4 * g + r) * DK + kb * 16 + fr] = acc[r];
            } else if (g == 0) UN[kb * 16 + fr] = acc[0];
        }
    }
    __syncthreads();
}

__device__ __forceinline__ void mlstm_scan(const Args& a, int vcu, int G) {
    unsigned char* ws = a.ws; const int tid = threadIdx.x;
    const float* BL = (const float*)(ws + WS_BL); const float* ML = (const float*)(ws + WS_MLOC);
    const float* UT = (const float*)(ws + WS_R1); bf16_t* CsT = (bf16_t*)(ws + WS_CST);
    const int gt = vcu * 512 + tid, NT = G * 512;
    for (int e2 = gt; e2 < 32 * 4096; e2 += NT) {
        const int bh = e2 >> 12, e = (e2 & 4095) * 2;
        f32x2 u[NCH];
#pragma unroll
        for (int c = 0; c < NCH; ++c) u[c] = *(const f32x2*)(UT + (size_t)(bh * NCH + c) * (DV * DK) + e);
        f32x2 C = (f32x2){0.f, 0.f}; float m = 0.f;
#pragma unroll
        for (int c = 0; c < NCH; ++c) {
            *(unsigned*)(CsT + (size_t)(bh * NCH + c) * (DV * DK) + e) = pk2(C.x, C.y);
            const float bl = BL[bh * NCH + c]; const float f = __expf(bl);
            C = C * f + u[c]; m = fmaxf(bl + m, ML[bh * NCH + c]);
        }
        const float sc = __expf(-m); const int dv = e >> 6, dk = e & 63;
        float* Cout = a.out + OUT_CP + (size_t)bh * (DK * DV);
        Cout[(size_t)dk * DV + dv] = C.x * sc; Cout[(size_t)(dk + 1) * DV + dv] = C.y * sc;
    }
    for (int e1 = gt; e1 < 32 * 64; e1 += NT) {
        const int bh = e1 >> 6, dk = e1 & 63;
        const float* UN = (const float*)(ws + WS_UN); float* Ns = (float*)(ws + WS_NS);
        float n = 0.f, m = 0.f;
        for (int c = 0; c < NCH; ++c) { Ns[(size_t)(bh * NCH + c) * DK + dk] = n; const float bl = BL[bh * NCH + c]; n = n * __expf(bl) + UN[(size_t)(bh * NCH + c) * DK + dk]; m = fmaxf(bl + m, ML[bh * NCH + c]); }
        a.out[OUT_NP + e1] = n * __expf(-m);
        if (dk == 0) a.out[OUT_MP + bh] = m;
    }
}

constexpr int C_QT = 0, C_KT = 64 * PK, C_VT = 2 * 64 * PK, C_CT = C_VT + 64 * PV, C_ST = C_CT + 144 * PK, C_GS = C_ST + 4 * 16 * PK, C_HALF = C_GS + 512;
static_assert(2 * C_HALF <= MISC_OFF, "stage C LDS");
__device__ __forceinline__ void mlstm_C_item(const Args& a, int item, LAS unsigned char* L, int ht, int hw, int lane) {
    unsigned char* ws = a.ws;
    const int bh = item >> 5, c = item & 31, b = bh >> 2, h = bh & 3, row0 = b * 2048 + c * 64;
    const bf16_t* U = (const bf16_t*)(ws + WS_U); const float* GT = (const float*)(ws + WS_GATES);
    LAS unsigned char* qt = L + C_QT; LAS unsigned char* kt = L + C_KT; LAS unsigned char* vt = L + C_VT; LAS unsigned char* ct = L + C_CT;
    LAS unsigned char* st = L + C_ST + hw * (16 * PK); LAS float* gsb = (LAS float*)(L + C_GS); LAS float* gsa = gsb + 64;
    {   const float lf = GT[(size_t)(row0 + lane) * 8 + 4 + h], ig = GT[(size_t)(row0 + lane) * 8 + h];
        const float bc = wave_incl_scan(lf, lane);
        if (hw == 0) { gsb[lane] = bc; gsa[lane] = ig - bc; } }
#pragma unroll
    for (int i = 0; i < 2; ++i) { const int idx = ht + 256 * i, s = idx >> 3, ch = idx & 7;
        *(LAS u32x4*)(qt + s * PK + ch * 16) = *(const u32x4*)(U + (size_t)(row0 + s) * NU + h * 64 + ch * 8);
        *(LAS u32x4*)(kt + s * PK + ch * 16) = *(const u32x4*)(U + (size_t)(row0 + s) * NU + 256 + h * 64 + ch * 8); }
#pragma unroll
    for (int i = 0; i < 4; ++i) { const int idx = ht + 256 * i, s = idx >> 4, ch = idx & 15;
        *(LAS u32x4*)(vt + s * PV + ch * 16) = *(const u32x4*)(U + (size_t)(row0 + s) * NU + 512 + h * 128 + ch * 8); }
    if (ht < 64) { *(LAS u32x4*)(vt + ht * PV + 256) = (u32x4){0x3F80u, 0u, 0u, 0u}; *(LAS u32x4*)(vt + ht * PV + 272) = (u32x4){0u, 0u, 0u, 0u}; }
    {   const bf16_t* CsT = (const bf16_t*)(ws + WS_CST) + (size_t)item * (DV * DK);
#pragma unroll
        for (int i = 0; i < 4; ++i) { const int idx = ht + 256 * i, dv = idx >> 3, ch = idx & 7; *(LAS u32x4*)(ct + dv * PK + ch * 16) = *(const u32x4*)(CsT + dv * DK + ch * 8); }
        const float* Ns = (const float*)(ws + WS_NS) + (size_t)item * DK;
        if (ht < 8) { const f32x4 n0 = *(const f32x4*)(Ns + ht * 8), n1 = *(const f32x4*)(Ns + ht * 8 + 4); *(LAS u32x4*)(ct + 128 * PK + ht * 16) = (u32x4){pk2(n0.x, n0.y), pk2(n0.z, n0.w), pk2(n1.x, n1.y), pk2(n1.z, n1.w)}; }
        else if (ht < 8 + 120) { const int j = ht - 8, r = 129 + (j >> 3), ch = j & 7; *(LAS u32x4*)(ct + r * PK + ch * 16) = (u32x4){0u, 0u, 0u, 0u}; }
    }
    __syncthreads();
    const int g = lane >> 4, fr = lane & 15, t0 = hw * 16;
    const bf16x8 aq0 = row_frag(qt, PK, t0, 0, lane), aq1 = row_frag(qt, PK, t0, 32, lane);
    float bt[4], ebt[4];
#pragma unroll
    for (int r = 0; r < 4; ++r) { bt[r] = gsb[t0 + 4 * g + r]; ebt[r] = __expf(bt[r]); }
#pragma unroll
    for (int j = 0; j < 4; ++j) {
        f32x4 sa = (f32x4){0.f, 0.f, 0.f, 0.f};
        sa = __builtin_amdgcn_mfma_f32_16x16x32_bf16(aq0, row_frag(kt, PK, 16 * j, 0, lane), sa, 0, 0, 0);
        sa = __builtin_amdgcn_mfma_f32_16x16x32_bf16(aq1, row_frag(kt, PK, 16 * j, 32, lane), sa, 0, 0, 0);
        const int s = 16 * j + fr; const float as = gsa[s];
#pragma unroll
        for (int r = 0; r < 4; ++r) { const int t = t0 + 4 * g + r; const float w = (s <= t) ? __expf(bt[r] + as) : 0.f;
            *(LAS bf16_t*)(st + (4 * g + r) * PK + s * 2) = (bf16_t)f2bf(sa[r] * w); }
    }
    LDS_WAIT(); asm volatile("" ::: "memory");
    const bf16x8 as0 = row_frag(st, PK, 0, 0, lane), as1 = row_frag(st, PK, 0, 32, lane);
    f32x4 hv[8]; float den[4];
    {
        f32x4 a1 = (f32x4){0.f, 0.f, 0.f, 0.f}, a2 = (f32x4){0.f, 0.f, 0.f, 0.f};
        a1 = __builtin_amdgcn_mfma_f32_16x16x32_bf16(as0, tr_frag(vt, PV, 0, 128, lane), a1, 0, 0, 0);
        a1 = __builtin_amdgcn_mfma_f32_16x16x32_bf16(as1, tr_frag(vt, PV, 32, 128, lane), a1, 0, 0, 0);
        a2 = __builtin_amdgcn_mfma_f32_16x16x32_bf16(aq0, row_frag(ct, PK, 128, 0, lane), a2, 0, 0, 0);
        a2 = __builtin_amdgcn_mfma_f32_16x16x32_bf16(aq1, row_frag(ct, PK, 128, 32, lane), a2, 0, 0, 0);
#pragma unroll
        for (int r = 0; r < 4; ++r) { const float dn = a1[r] + ebt[r] * a2[r]; den[r] = 1.0f / fmaxf(fabsf(__shfl(dn, lane & 48)), 1.0f); }
    }
    float ss[4] = {0.f, 0.f, 0.f, 0.f};
#pragma unroll
    for (int db = 0; db < 8; ++db) {
        f32x4 a1 = (f32x4){0.f, 0.f, 0.f, 0.f}, a2 = (f32x4){0.f, 0.f, 0.f, 0.f};
        a1 = __builtin_amdgcn_mfma_f32_16x16x32_bf16(as0, tr_frag(vt, PV, 0, db * 16, lane), a1, 0, 0, 0);
        a1 = __builtin_amdgcn_mfma_f32_16x16x32_bf16(as1, tr_frag(vt, PV, 32, db * 16, lane), a1, 0, 0, 0);
        a2 = __builtin_amdgcn_mfma_f32_16x16x32_bf16(aq0, row_frag(ct, PK, db * 16, 0, lane), a2, 0, 0, 0);
        a2 = __builtin_amdgcn_mfma_f32_16x16x32_bf16(aq1, row_frag(ct, PK, db * 16, 32, lane), a2, 0, 0, 0);
#pragma unroll
        for (int r = 0; r < 4; ++r) { const float hh = (a1[r] + ebt[r] * a2[r]) * den[r]; hv[db][r] = hh; ss[r] += hh * hh; }
    }
#pragma unroll
    for (int r = 0; r < 4; ++r) { float s = ss[r]; s += __shfl_xor(s, 1); s += __shfl_xor(s, 2); s += __shfl_xor(s, 4); s += __shfl_xor(s, 8); ss[r] = 1.0f / sqrtf(s * (1.f / DV) + EPS); }
    bf16_t* MIX = (bf16_t*)(ws + WS_R2); const float* gmh = a.in[I_GMH] + h * DV;
#pragma unroll
    for (int db = 0; db < 8; ++db) { const int dv = db * 16 + fr; const float gm = gmh[dv];
#pragma unroll
        for (int r = 0; r < 4; ++r) { const size_t row = (size_t)(row0 + t0 + 4 * g + r);
            const float og = bf1(U[row * NU + 1024 + h * DV + dv]);
            MIX[row * DM + h * DV + dv] = (bf16_t)f2bf(hv[db][r] * ss[r] * gm * sigmoidf_(og)); } }
    __syncthreads();
}

__device__ __forceinline__ void mlstm_sample_item(const Args& a, int item, LAS unsigned char* L, int ht, int lane) {
    unsigned char* ws = a.ws;
    const int b = item >> 2, h = item & 3, row0 = TP + b * 4;
    const bf16_t* U = (const bf16_t*)(ws + WS_U); const float* GT = (const float*)(ws + WS_GATES);
    LAS float* q = (LAS float*)L;
    LAS float* k = q + 256;
    LAS float* v = k + 256;
    LAS float* n0 = v + 512;
    LAS float* qk = n0 + 64;
    LAS float* qn = qk + 16;
    LAS float* qc = qn + 16;
    LAS float* red = qc + 1024;
    {   const int t = ht >> 6, d = ht & 63;
        q[ht] = bf1(U[(size_t)(row0 + t) * NU + h * 64 + d]); k[ht] = bf1(U[(size_t)(row0 + t) * NU + 256 + h * 64 + d]);
        v[ht] = bf1(U[(size_t)(row0 + (ht >> 7)) * NU + 512 + h * 128 + (ht & 127)]); v[ht + 256] = bf1(U[(size_t)(row0 + 2 + (ht >> 7)) * NU + 512 + h * 128 + (ht & 127)]);
        if (ht < 64) n0[ht] = a.in[I_SN][(size_t)item * 64 + ht]; }
    float bt[4], igt[4]; { float cs = 0.f;
#pragma unroll
        for (int t = 0; t < 4; ++t) { cs += GT[(size_t)(row0 + t) * 8 + 4 + h]; bt[t] = cs; igt[t] = GT[(size_t)(row0 + t) * 8 + h]; } }
    const float m0 = a.in[I_SM][item], bL = bt[3];
    float mnew = bL + m0;
#pragma unroll
    for (int s = 0; s < 4; ++s) mnew = fmaxf(mnew, bL - bt[s] + igt[s]);
    const float ast = __expf(bL + m0 - mnew); float wk[4];
#pragma unroll
    for (int s = 0; s < 4; ++s) wk[s] = __expf(bL - bt[s] + igt[s] - mnew);
    __syncthreads();
    if (ht < 16) { const int t = ht >> 2, s = ht & 3; float d = 0.f; for (int i = 0; i < 64; ++i) d += q[t * 64 + i] * k[s * 64 + i]; qk[ht] = d; }
    else if (ht < 20) { const int t = ht - 16; float d = 0.f; for (int i = 0; i < 64; ++i) d += q[t * 64 + i] * n0[i]; qn[t] = d; }
    {   const int dv = ht & 127, dkh = ht >> 7;
        const float* C0 = a.in[I_SC] + (size_t)item * (DK * DV); float* C1 = a.out + OUT_CS + (size_t)item * (DK * DV);
        float vv[4];
#pragma unroll
        for (int s = 0; s < 4; ++s) vv[s] = v[s * 128 + dv] * wk[s];
        float p[4] = {0.f, 0.f, 0.f, 0.f};
#pragma unroll 8
        for (int i = 0; i < 32; ++i) { const int dk = dkh * 32 + i; const float c0 = C0[(size_t)dk * DV + dv];
            float cn = ast * c0;
#pragma unroll
            for (int s = 0; s < 4; ++s) { cn += k[s * 64 + dk] * vv[s]; p[s] += q[s * 64 + dk] * c0; }
            C1[(size_t)dk * DV + dv] = cn; }
#pragma unroll
        for (int t = 0; t < 4; ++t) qc[(dkh * 4 + t) * 128 + dv] = p[t];
        if (ht < 64) { float nn = ast * n0[ht];
#pragma unroll
            for (int s = 0; s < 4; ++s) nn += wk[s] * k[s * 64 + ht];
            a.out[OUT_NS + (size_t)item * 64 + ht] = nn; }
        if (ht == 0) a.out[OUT_MS + item] = mnew;
    }
    __syncthreads();
    float hh[4];
    if (ht < 128) {
        const int dv = ht;
#pragma unroll
        for (int t = 0; t < 4; ++t) {
            float mt = bt[t] + m0;
#pragma unroll
            for (int s = 0; s < 4; ++s) if (s <= t) mt = fmaxf(mt, bt[t] - bt[s] + igt[s]);
            const float wi = __expf(bt[t] + m0 - mt);
            float num = wi * (qc[t * 128 + dv] + qc[(4 + t) * 128 + dv]), dn = wi * qn[t];
#pragma unroll
            for (int s = 0; s < 4; ++s) if (s <= t) { const float sv = qk[t * 4 + s] * __expf(bt[t] - bt[s] + igt[s] - mt); num += sv * v[s * 128 + dv]; dn += sv; }
            hh[t] = num / fmaxf(fabsf(dn), __expf(-mt));
            const float s2 = wave_sum(hh[t] * hh[t]);
            if (lane == 0) red[(ht >> 6) * 4 + t] = s2;
        }
    }
    __syncthreads();
    if (ht < 128) {
        const int dv = ht; bf16_t* MIX = (bf16_t*)(ws + WS_R2); const float gm = a.in[I_GMH][h * DV + dv];
#pragma unroll
        for (int t = 0; t < 4; ++t) { const float rn = 1.0f / sqrtf((red[t] + red[4 + t]) * (1.f / DV) + EPS);
            const float og = bf1(U[(size_t)(row0 + t) * NU + 1024 + h * DV + dv]);
            MIX[(size_t)(row0 + t) * DM + h * DV + dv] = (bf16_t)f2bf(hh[t] * rn * gm * sigmoidf_(og)); }
    }
    __syncthreads();
}

__device__ __forceinline__ void conv_phase(const Args& a, int vcu, int G) {
    unsigned char* ws = a.ws; const bf16_t* U = (const bf16_t*)(ws + WS_U); bf16_t* MIX = (bf16_t*)(ws + WS_R2);
    const float* cw = a.in[I_CONVW];
    const int gt = vcu * 512 + threadIdx.x, NT = G * 512;
    for (int it = gt; it < TT * 64; it += NT) {
        const int row = it >> 6, ch = (it & 63) * 8;
        int t, bsm = 0; const bool prm = row < TP;
        if (prm) t = row & 2047; else { t = (row - TP) & 3; bsm = (row - TP) >> 2; }
        float z[3][8];
#pragma unroll
        for (int d = 0; d < 3; ++d) {
            const int tt = t - 2 + d;
            if (tt >= 0) { const u32x4 cg = *(const u32x4*)(U + (size_t)(row - 2 + d) * NU + 2048 + ch), hc = *(const u32x4*)(U + (size_t)(row - 2 + d) * NU + 2560 + ch);
                z[d][0] = bf_lo(cg.x) * bf_lo(hc.x); z[d][1] = bf_hi(cg.x) * bf_hi(hc.x); z[d][2] = bf_lo(cg.y) * bf_lo(hc.y); z[d][3] = bf_hi(cg.y) * bf_hi(hc.y);
                z[d][4] = bf_lo(cg.z) * bf_lo(hc.z); z[d][5] = bf_hi(cg.z) * bf_hi(hc.z); z[d][6] = bf_lo(cg.w) * bf_lo(hc.w); z[d][7] = bf_hi(cg.w) * bf_hi(hc.w); }
            else if (!prm) { const float* sc = a.in[I_SCV] + ((size_t)bsm * 2 + (2 + tt)) * 512 + ch; const f32x4 s0 = *(const f32x4*)sc, s1 = *(const f32x4*)(sc + 4);
                z[d][0] = s0.x; z[d][1] = s0.y; z[d][2] = s0.z; z[d][3] = s0.w; z[d][4] = s1.x; z[d][5] = s1.y; z[d][6] = s1.z; z[d][7] = s1.w; }
            else {
#pragma unroll
                for (int e = 0; e < 8; ++e) z[d][e] = 0.f; }
        }
        const u32x4 bgw = *(const u32x4*)(U + (size_t)row * NU + 1536 + ch);
        const float bg[8] = {bf_lo(bgw.x), bf_hi(bgw.x), bf_lo(bgw.y), bf_hi(bgw.y), bf_lo(bgw.z), bf_hi(bgw.z), bf_lo(bgw.w), bf_hi(bgw.w)};
        float y[8];
#pragma unroll
        for (int e = 0; e < 8; ++e) y[e] = bg[e] * (cw[ch + e] * z[0][e] + cw[512 + ch + e] * z[1][e] + cw[1024 + ch + e] * z[2][e]);
        *(u32x4*)(MIX + (size_t)row * DM + 512 + ch) = (u32x4){pk2(y[0], y[1]), pk2(y[2], y[3]), pk2(y[4], y[5]), pk2(y[6], y[7])};
        float* cvo = nullptr;
        if (prm && t >= 2046) cvo = a.out + OUT_CVP + ((size_t)(row >> 11) * 2 + (t - 2046)) * 512 + ch;
        if (!prm && t >= 2) cvo = a.out + OUT_CVS + ((size_t)bsm * 2 + (t - 2)) * 512 + ch;
        if (cvo) { *(f32x4*)cvo = (f32x4){z[2][0], z[2][1], z[2][2], z[2][3]}; *(f32x4*)(cvo + 4) = (f32x4){z[2][4], z[2][5], z[2][6], z[2][7]}; }
    }
}

__device__ __forceinline__ void final_norm(const Args& a, int vcu, int G) {
    const int lane = threadIdx.x & 63, wave = threadIdx.x >> 6; const int gw = vcu * 8 + wave, NGW = G * 8;
    const float* ssq = (const float*)(a.ws + WS_SSQ3); const float* gf = a.in[I_GFINAL]; float* Y = a.out + OUT_Y;
    f32x4 g[4];
#pragma unroll
    for (int j = 0; j < 4; ++j) g[j] = *(const f32x4*)(gf + 4 * lane + 256 * j);
    for (int m = gw; m < TT; m += NGW) {
        const float rs = row_rs(ssq, m);
#pragma unroll
        for (int j = 0; j < 4; ++j) { f32x4* p = (f32x4*)(Y + (size_t)m * DM + 4 * lane + 256 * j); *p = *p * rs * g[j]; }
    }
}

constexpr int N_PHASES = 10;
__global__ void __launch_bounds__(512, 2) hymba_fwd(Args args) {
    extern __shared__ __attribute__((aligned(16))) unsigned char lds_raw[];
    LAS unsigned char* lds = (LAS unsigned char*)lds_raw;
    volatile LAS unsigned* MISC = (volatile LAS unsigned*)(lds + MISC_OFF);
    const int tid = threadIdx.x, lane = tid & 63, wave = __builtin_amdgcn_readfirstlane(tid >> 6);
    const int G = gridDim.x; const int bx = blockIdx.x; const int vcu = (G % 8 == 0) ? (bx % 8) * (G / 8) + bx / 8 : bx;
    unsigned char* ws = args.ws;
    for (int u = tid; u < 64; u += 512) MISC[u] = 0u;
    __syncthreads();
    XcdBarrier bar; bar.bar = (unsigned*)(ws + WS_CTL) + CW_BAR + args.li * XCD_BAR_WORDS; bar.x = 0; bar.st = nullptr;
    if (MK_N_LAUNCHES != N_PHASES) bar = xcd_barrier_post((unsigned*)(ws + WS_CTL) + CW_BAR + args.li * XCD_BAR_WORDS, MISC + 8);
    const int lo = args.ph_lo, hi = args.ph_hi;
#define IN(k) (lo <= (k) && (k) < hi)
#define SEAM(k) do { if (IN(k) && IN((k) + 1)) xcd_barrier(bar); } while (0)
    Ctx X; X.a = &args; X.ws = ws;
    const int hb = tid >> 8, ht = tid & 255, hw = wave & 3;

    if (IN(0)) { p0_prologue(args, lds, vcu, G); } SEAM(0);
    if (IN(1)) { SchedOne S{K_IN, NPAN, 12, NPAN * 12, G, bx}; pg8::gemm_stream(lds, S, X); } SEAM(1);
    if (IN(2)) {
        for (int it = vcu * 2 + hb; it < 1024; it += 2 * G) mlstm_A_item(ws, it, lds + hb * (64 * PK + 64 * PV), ht, hw, lane);
        for (int it = vcu * 2 + hb; it < 512; it += 2 * G) mlstm_sample_item(args, it, lds + hb * 16384, ht, lane);
        conv_phase(args, vcu, G);
    } SEAM(2);
    if (IN(3)) { mlstm_scan(args, vcu, G); } SEAM(3);
    if (IN(4)) { for (int it = vcu * 2 + hb; it < 1024; it += 2 * G) mlstm_C_item(args, it, lds + hb * C_HALF, ht, hw, lane); } SEAM(4);
    if (IN(5)) { SchedP3 S{G, bx}; pg8::gemm_stream(lds, S, X); } SEAM(5);
    if (IN(6)) { SchedOne S{K_GU, NPAN, 22, NPAN * 22, G, bx}; pg8::gemm_stream(lds, S, X); } SEAM(6);
    if (IN(7)) { SchedOne S{K_DOWN, NPAN, 4, NPAN * 4, G, bx}; pg8::gemm_stream(lds, S, X); } SEAM(7);
    if (IN(8)) { SchedOne S{K_PG, NPAN, 4, NPAN * 4, G, bx}; pg8::gemm_stream(lds, S, X); } SEAM(8);
    if (IN(9)) { final_norm(args, vcu, G); }
#undef IN
#undef SEAM
}

extern "C" void kernel_launch(void* const* d_in, const int* in_sizes, int n_in, void* d_out, int out_size, void* d_ws, size_t ws_size, hipStream_t stream) {
    static int grid = 0;
    if (grid == 0) {
        if (n_in != 23 || (size_t)out_size != OUT_END || ws_size < WS_END) { fprintf(stderr, "kernel_launch: unexpected shapes (n_in %d, out %d, ws %zu)\n", n_in, out_size, ws_size); grid = -1; return; }
        int dev = 0, cus = 0, per_cu = 0;
        if (hipGetDevice(&dev) != hipSuccess || hipDeviceGetAttribute(&cus, hipDeviceAttributeMultiprocessorCount, dev) != hipSuccess) { grid = -1; return; }
        if (hipFuncSetAttribute((const void*)hymba_fwd, hipFuncAttributeMaxDynamicSharedMemorySize, LDS_BYTES) != hipSuccess) { fprintf(stderr, "kernel_launch: hipFuncSetAttribute failed\n"); grid = -1; return; }
        if (hipOccupancyMaxActiveBlocksPerMultiprocessor(&per_cu, (const void*)hymba_fwd, 512, LDS_BYTES) != hipSuccess || per_cu < 1) { fprintf(stderr, "kernel_launch: occupancy query says %d\n", per_cu); per_cu = 1; }
        (void)hipGetLastError();
        grid = cus;
    }
    if (grid < 0) return;
    (void)hipMemsetAsync((char*)d_ws + WS_CTL, 0, CTL_ZERO_BYTES, stream);
    Args a{};
    for (int i = 0; i < 23; ++i) a.in[i] = (const float*)d_in[i];
    a.out = (float*)d_out; a.ws = (unsigned char*)d_ws;
    constexpr int NL = MK_N_LAUNCHES;
    for (int li = 0; li < NL; ++li) {
        a.ph_lo = (NL == 1) ? 0 : li; a.ph_hi = (NL == 1) ? N_PHASES : li + 1; a.li = (NL == 1) ? 0 : 0;
        void* kargs[] = {&a};
        hipError_t le;
        if (NL == 1) le = hipLaunchCooperativeKernel((const void*)hymba_fwd, dim3(grid), dim3(512), kargs, LDS_BYTES, stream);
        else { hipLaunchKernelGGL(hymba_fwd, dim3(grid), dim3(512), LDS_BYTES, stream, a); le = hipPeekAtLastError(); }
        if (le != hipSuccess) { fprintf(stderr, "kernel_launch: launch %d failed: %s\n", li, hipGetErrorName(le)); break; }
    }
}
```
